# Optimizing an MI355X kernel written in HIP

```python
import math
import jax, jax.numpy as jnp
from jax import lax
import numpy as np

D_MODEL = 1024
BATCH = 2
SEQ = 8192
DEPTH = 2

GRID_W = 64
CTX_LEN = 256
HEAD_DIM = 64
N_Q_HEADS = 8
N_KV_HEADS = 2
Q_PER_KV = N_Q_HEADS // N_KV_HEADS
ATTN_WIDTH = N_Q_HEADS * HEAD_DIM
KV_WIDTH = N_KV_HEADS * HEAD_DIM
WINDOW = 128
BLOCK = 128
ROPE_BASE = 10000.0
POOL_WINDOWS = (2, 4, 8, 16)
POOL_GROUP = 64
POOL_WIDTH = POOL_GROUP * len(POOL_WINDOWS)
CONV_WIDTH = 256
CONV_K = 31
N_BRANCH = 3
SPLIT_POOL = POOL_WIDTH
SPLIT_Q = SPLIT_POOL + ATTN_WIDTH
SPLIT_K = SPLIT_Q + KV_WIDTH
SPLIT_V = SPLIT_K + KV_WIDTH
SPLIT_CONV = SPLIT_V + 2 * CONV_WIDTH
IN_WIDTH = SPLIT_CONV + N_BRANCH * D_MODEL
D_FF = 4 * D_MODEL
ALPHA = (2 * DEPTH) ** 0.25
BETA = (8 * DEPTH) ** -0.25
LN_EPS = 1e-5
NEG = -1e30

kernel_name = "hybrid_pool_swa_conformer_deepnorm_dit"


def _layer_norm(x):
    xf = x.astype(jnp.float32)
    mu = jnp.mean(xf, axis=-1, keepdims=True)
    var = jnp.mean(jnp.square(xf - mu), axis=-1, keepdims=True)
    return ((xf - mu) * lax.rsqrt(var + LN_EPS)).astype(x.dtype)


def _modulate(x, shift, scale):
    return _layer_norm(x) * (1 + scale) + shift


def _post_norm(x, gate, y, g, b):
    return _layer_norm(ALPHA * x + gate * y) * g + b


def _pool_mixer(u, pool_w, pool_scale):
    B, L, _ = u.shape
    uf = u.astype(jnp.float32)
    cs = jnp.concatenate([jnp.zeros((B, 1, POOL_WIDTH), jnp.float32), jnp.cumsum(uf, axis=1)], axis=1)
    t = jnp.arange(L)
    outs = []
    for g, w in enumerate(POOL_WINDOWS):
        lo = jnp.clip(t - w // 2, 0, L)
        hi = jnp.clip(t + w - w // 2, 0, L)
        csg = cs[..., g * POOL_GROUP:(g + 1) * POOL_GROUP]
        cnt = (hi - lo).astype(jnp.float32)[None, :, None]
        outs.append((csg[:, hi] - csg[:, lo]) / cnt)
    pooled = jnp.concatenate(outs, axis=-1)
    d = (pooled - uf).astype(u.dtype).reshape(B, L, len(POOL_WINDOWS), POOL_GROUP)
    y = jnp.einsum('blgc,gcd->blgd', d, pool_w).reshape(B, L, POOL_WIDTH)
    return y * pool_scale


def _axial_rope(x, row_pos, col_pos):
    half = HEAD_DIM // 2
    quarter = half // 2
    inv = ROPE_BASE ** (-jnp.arange(quarter, dtype=jnp.float32) / quarter)

    def rot(xa, pos):
        ang = pos.astype(jnp.float32)[:, None] * inv[None, :]
        cos = jnp.cos(ang)[None, :, None, :]
        sin = jnp.sin(ang)[None, :, None, :]
        x1, x2 = xa[..., :quarter], xa[..., quarter:]
        return jnp.concatenate([x1 * cos - x2 * sin, x1 * sin + x2 * cos], axis=-1)

    xf = x.astype(jnp.float32)
    out = jnp.concatenate([rot(xf[..., :half], row_pos), rot(xf[..., half:], col_pos)], axis=-1)
    return out.astype(x.dtype)


def _latent_attention(q, k, v, kc, vc, sink):
    B, L = q.shape[0], q.shape[1]
    C = kc.shape[1]
    nb = L // BLOCK
    scale = HEAD_DIM ** -0.5
    qb = q.reshape(B, nb, BLOCK, N_KV_HEADS, Q_PER_KV, HEAD_DIM)
    pad = jnp.zeros((B, BLOCK, N_KV_HEADS, HEAD_DIM), k.dtype)

    def band(t):
        tp = jnp.concatenate([pad, t, pad], axis=1).reshape(B, nb + 2, BLOCK, N_KV_HEADS, HEAD_DIM)
        return jnp.concatenate([tp[:, :-2], tp[:, 1:-1], tp[:, 2:]], axis=2)

    kb, vb = band(k), band(v)
    s_loc = jnp.einsum('bnqhgd,bnkhd->bnhgqk', qb, kb).astype(jnp.float32) * scale
    qi = jnp.arange(nb)[:, None, None] * BLOCK + jnp.arange(BLOCK)[None, :, None]
    kj = (jnp.arange(nb)[:, None, None] - 1) * BLOCK + jnp.arange(3 * BLOCK)[None, None, :]
    valid = (jnp.abs(qi - kj) <= WINDOW) & (kj >= 0) & (kj < L)
    s_loc = jnp.where(valid[None, :, None, None], s_loc, NEG)
    s_ctx = jnp.einsum('bnqhgd,bchd->bnhgqc', qb, kc).astype(jnp.float32) * scale
    s_sink = jnp.broadcast_to(
        sink.reshape(N_KV_HEADS, Q_PER_KV)[None, None, :, :, None, None].astype(jnp.float32),
        s_loc.shape[:-1] + (1,))
    p = jax.nn.softmax(jnp.concatenate([s_loc, s_ctx, s_sink], axis=-1), axis=-1)
    p_loc = p[..., :3 * BLOCK].astype(v.dtype)
    p_ctx = p[..., 3 * BLOCK:3 * BLOCK + C].astype(v.dtype)
    o = (jnp.einsum('bnhgqk,bnkhd->bnqhgd', p_loc, vb)
         + jnp.einsum('bnhgqc,bchd->bnqhgd', p_ctx, vc))
    return o.reshape(B, L, ATTN_WIDTH)


def _context_attention(qc, kc, vc, sink):
    B, C = qc.shape[0], qc.shape[1]
    scale = HEAD_DIM ** -0.5
    s = jnp.einsum('bqhgd,bkhd->bhgqk', qc, kc).astype(jnp.float32) * scale
    s_sink = jnp.broadcast_to(
        sink.reshape(N_KV_HEADS, Q_PER_KV)[None, :, :, None, None].astype(jnp.float32),
        s.shape[:-1] + (1,))
    p = jax.nn.softmax(jnp.concatenate([s, s_sink], axis=-1), axis=-1)
    o = jnp.einsum('bhgqk,bkhd->bqhgd', p[..., :C].astype(vc.dtype), vc)
    return o.reshape(B, C, ATTN_WIDTH)


def _conv_module(u, conv_w, conv_b, ln_g, ln_b, w_proj):
    a, b = jnp.split(u, 2, axis=-1)
    glu = a * jax.nn.sigmoid(b)
    y = lax.conv_general_dilated(glu, conv_w[:, None, :], window_strides=(1,),
                                 padding=[(CONV_K // 2, CONV_K // 2)],
                                 dimension_numbers=('NWC', 'WIO', 'NWC'),
                                 feature_group_count=CONV_WIDTH) + conv_b
    y = jax.nn.silu(_layer_norm(y) * ln_g + ln_b)
    return y @ w_proj


def _split_in(z):
    return jnp.split(z, [SPLIT_POOL, SPLIT_Q, SPLIT_K, SPLIT_V, SPLIT_CONV], axis=-1)


def _merge(gates, o_attn, u_pool, u_conv, pool_w, pool_scale, w_pool_out, w_attn_out,
           conv_w, conv_b, conv_ln_g, conv_ln_b, w_conv_out, w_out):
    y_pool = _pool_mixer(u_pool, pool_w, pool_scale) @ w_pool_out
    y_attn = o_attn @ w_attn_out
    y_conv = _conv_module(u_conv, conv_w, conv_b, conv_ln_g, conv_ln_b, w_conv_out)
    g = jax.nn.sigmoid(gates.astype(jnp.float32)).astype(gates.dtype)
    g_pool, g_attn, g_conv = jnp.split(g, N_BRANCH, axis=-1)
    return (g_pool * y_pool + g_attn * y_attn + g_conv * y_conv) @ w_out


def _mlp(h, w1, b1, w2, b2):
    return jnp.square(jax.nn.relu(h @ w1 + b1)) @ w2 + b2


def setup_inputs(seed: int = 0) -> dict:
    key = jax.random.key(seed)
    ks = jax.random.split(key, 32)
    f = jnp.float32
    D = D_MODEL

    def nrm(k, shape, s):
        return jax.random.normal(k, shape, f) * s

    return {
        "x": nrm(ks[0], (BATCH, SEQ, D), 1.0),
        "c": nrm(ks[1], (BATCH, D), 1.0),
        "ctx": nrm(ks[2], (BATCH, CTX_LEN, D), 1.0),
        "c_ctx": nrm(ks[3], (D,), 1.0),
        "w_mod": nrm(ks[4], (DEPTH, D, 6 * D), 0.5 * D ** -0.5),
        "b_mod": nrm(ks[5], (DEPTH, 6 * D), 0.02),
        "w_in": nrm(ks[6], (DEPTH, D, IN_WIDTH), D ** -0.5),
        "b_in": nrm(ks[7], (DEPTH, IN_WIDTH), 0.02),
        "pool_w": nrm(ks[8], (DEPTH, len(POOL_WINDOWS), POOL_GROUP, POOL_GROUP), POOL_GROUP ** -0.5),
        "pool_scale": 1.0 + nrm(ks[9], (DEPTH, POOL_WIDTH), 0.02),
        "w_pool_out": nrm(ks[10], (DEPTH, POOL_WIDTH, D), POOL_WIDTH ** -0.5),
        "attn_sink": nrm(ks[11], (DEPTH, N_Q_HEADS), 0.5),
        "w_attn_out": nrm(ks[12], (DEPTH, ATTN_WIDTH, D), ATTN_WIDTH ** -0.5),
        "conv_w": nrm(ks[13], (DEPTH, CONV_K, CONV_WIDTH), CONV_K ** -0.5),
        "conv_b": nrm(ks[14], (DEPTH, CONV_WIDTH), 0.02),
        "conv_ln_g": 1.0 + nrm(ks[15], (DEPTH, CONV_WIDTH), 0.02),
        "conv_ln_b": nrm(ks[16], (DEPTH, CONV_WIDTH), 0.02),
        "w_conv_out": nrm(ks[17], (DEPTH, CONV_WIDTH, D), CONV_WIDTH ** -0.5),
        "w_out": nrm(ks[18], (DEPTH, D, D), BETA * D ** -0.5),
        "ln1_g": 1.0 + nrm(ks[19], (DEPTH, D), 0.02),
        "ln1_b": nrm(ks[20], (DEPTH, D), 0.02),
        "w_mlp1": nrm(ks[21], (DEPTH, D, D_FF), D ** -0.5),
        "b_mlp1": nrm(ks[22], (DEPTH, D_FF), 0.02),
        "w_mlp2": nrm(ks[23], (DEPTH, D_FF, D), BETA * D_FF ** -0.5),
        "b_mlp2": nrm(ks[24], (DEPTH, D), 0.02),
        "ln2_g": 1.0 + nrm(ks[25], (DEPTH, D), 0.02),
        "ln2_b": nrm(ks[26], (DEPTH, D), 0.02),
    }


def reference(x, c, ctx, c_ctx, w_mod, b_mod, w_in, b_in, pool_w, pool_scale, w_pool_out,
              attn_sink, w_attn_out, conv_w, conv_b, conv_ln_g, conv_ln_b, w_conv_out, w_out,
              ln1_g, ln1_b, w_mlp1, b_mlp1, w_mlp2, b_mlp2, ln2_g, ln2_b):
    B, L, _ = x.shape
    C = ctx.shape[1]
    rows = L // GRID_W
    row_pos = jnp.repeat(jnp.arange(rows, dtype=jnp.int32), GRID_W)
    col_pos = jnp.tile(jnp.arange(GRID_W, dtype=jnp.int32), rows)
    silu_c = jax.nn.silu(c)
    silu_cc = jax.nn.silu(c_ctx)
    xl, xc = x, ctx
    for i in range(DEPTH):
        last = i == DEPTH - 1
        mod_l = (silu_c @ w_mod[i] + b_mod[i])[:, None, :]
        mod_c = silu_cc @ w_mod[i] + b_mod[i]
        sh1_l, sc1_l, g1_l, sh2_l, sc2_l, g2_l = jnp.split(mod_l, 6, axis=-1)
        sh1_c, sc1_c, g1_c, sh2_c, sc2_c, g2_c = jnp.split(mod_c, 6, axis=-1)
        branch_params = (pool_w[i], pool_scale[i], w_pool_out[i], w_attn_out[i], conv_w[i], conv_b[i],
                         conv_ln_g[i], conv_ln_b[i], w_conv_out[i], w_out[i])

        hl = _modulate(xl, sh1_l, sc1_l)
        hc = _modulate(xc, sh1_c, sc1_c)
        ul_pool, ul_q, ul_k, ul_v, ul_conv, ul_gate = _split_in(hl @ w_in[i] + b_in[i])
        uc_pool, uc_q, uc_k, uc_v, uc_conv, uc_gate = _split_in(hc @ w_in[i] + b_in[i])
        kc = uc_k.reshape(B, C, N_KV_HEADS, HEAD_DIM)
        vc = uc_v.reshape(B, C, N_KV_HEADS, HEAD_DIM)
        ql = _axial_rope(ul_q.reshape(B, L, N_Q_HEADS, HEAD_DIM), row_pos, col_pos)
        ql = ql.reshape(B, L, N_KV_HEADS, Q_PER_KV, HEAD_DIM)
        kl = _axial_rope(ul_k.reshape(B, L, N_KV_HEADS, HEAD_DIM), row_pos, col_pos)
        vl = ul_v.reshape(B, L, N_KV_HEADS, HEAD_DIM)
        ol = _latent_attention(ql, kl, vl, kc, vc, attn_sink[i])
        yl = _merge(ul_gate, ol, ul_pool, ul_conv, *branch_params)
        xl_new = _post_norm(xl, g1_l, yl, ln1_g[i], ln1_b[i])
        if not last:
            oc = _context_attention(uc_q.reshape(B, C, N_KV_HEADS, Q_PER_KV, HEAD_DIM), kc, vc, attn_sink[i])
            yc = _merge(uc_gate, oc, uc_pool, uc_conv, *branch_params)
            xc = _post_norm(xc, g1_c, yc, ln1_g[i], ln1_b[i])
        xl = xl_new

        yl = _mlp(_modulate(xl, sh2_l, sc2_l), w_mlp1[i], b_mlp1[i], w_mlp2[i], b_mlp2[i])
        xl = _post_norm(xl, g2_l, yl, ln2_g[i], ln2_b[i])
        if not last:
            yc = _mlp(_modulate(xc, sh2_c, sc2_c), w_mlp1[i], b_mlp1[i], w_mlp2[i], b_mlp2[i])
            xc = _post_norm(xc, g2_c, yc, ln2_g[i], ln2_b[i])
    return xl
```

```cpp
#include <hip/hip_runtime.h>
#include <cstdio>
#include <cstdint>

typedef unsigned short bf16;
typedef unsigned u32x4 __attribute__((ext_vector_type(4)));
typedef float f32x4 __attribute__((ext_vector_type(4)));

constexpr int D = 1024, LSEQ = 8192, CTXL = 256, NB = 2, ML = NB * LSEQ, MC = NB * CTXL, MT = ML + MC;
constexpr int INW = 4608, FF = 4096, NMOD = 6 * D, DEPTH = 2;
constexpr int PW = 256, AW = 512, KVW = 128, CW = 256;
constexpr float ALPHA = 1.4142135623730951f, LN_EPS = 1e-5f, LOG2E = 1.4426950408889634f, C2 = 0.125f * LOG2E;
constexpr int GTL = LSEQ + 32, GTC = CTXL + 32;

constexpr size_t MiB = 1u << 20;
constexpr size_t WS_CTL = 0;
constexpr size_t WS_MOD = 1 * MiB;
constexpr size_t WS_XC = 8 * MiB;
constexpr size_t WS_H = 68 * MiB;
constexpr size_t WS_G = 101 * MiB;
constexpr size_t WS_Q = 200 * MiB;
constexpr size_t WS_UP = WS_Q + (size_t)MT * 512 * 2;
constexpr size_t WS_K = WS_UP + (size_t)MT * 256 * 2;
constexpr size_t WS_VT = WS_K + (size_t)MT * 128 * 2;
constexpr size_t WS_VTC = WS_VT + (size_t)4 * 64 * LSEQ * 2;
constexpr size_t WS_GT = 233 * MiB;
constexpr size_t WS_GTC = WS_GT + (size_t)2 * 256 * GTL * 2;
constexpr size_t WS_E = 242 * MiB;
constexpr size_t WS_MG = 200 * MiB;
constexpr size_t WS_HID = 101 * MiB;
constexpr size_t WS_END = 256 * MiB;
static_assert(WS_VTC + (size_t)4 * 64 * CTXL * 2 <= WS_GT, "map");
static_assert(WS_GTC + (size_t)2 * 256 * GTC * 2 <= WS_E, "map");
static_assert(WS_E + (size_t)MT * 256 * 2 <= WS_END, "map");
static_assert(WS_HID + (size_t)MT * FF * 2 <= WS_GT, "map");
static_assert(WS_G + (size_t)MT * 3072 * 2 <= WS_Q, "map");
static_assert(WS_H + (size_t)MT * D * 2 <= WS_G, "map");

__device__ __forceinline__ float bf2f(bf16 v) { return __uint_as_float((unsigned)v << 16); }
__device__ __forceinline__ bf16 f2bf(float f) { unsigned u = __float_as_uint(f); return (bf16)((u + 0x7fffu + ((u >> 16) & 1u)) >> 16); }
__device__ __forceinline__ float sigmoidf_(float x) { return 1.0f / (1.0f + __expf(-x)); }
__device__ __forceinline__ float siluf_(float x) { return x / (1.0f + __expf(-x)); }
__device__ __forceinline__ void row_info(int r, int& b, int& t, int& v, bool& isctx) {
    if (r < ML) { b = r >> 13; t = r & (LSEQ - 1); v = b; isctx = false; }
    else { const int rc = r - ML; b = rc >> 8; t = rc & (CTXL - 1); v = 2; isctx = true; }
}
__device__ __forceinline__ int perm16(int t) { return (t & ~12) | ((t & 8) >> 1) | ((t & 4) << 1); }
__device__ __forceinline__ float wave_sum(float v) {
#pragma unroll
    for (int o = 1; o < 64; o <<= 1) v += __shfl_xor(v, o);
    return v;
}
__device__ __forceinline__ float wave_max(float v) {
#pragma unroll
    for (int o = 1; o < 64; o <<= 1) v = fmaxf(v, __shfl_xor(v, o));
    return v;
}

__global__ void __launch_bounds__(256) n_mod(const float* c, const float* cctx, const float* w_mod, const float* b_mod, float* MOD) {
    __shared__ float sl[3][D];
    __shared__ float red[4][3][64];
    const int l = blockIdx.x / 96, cb = blockIdx.x % 96, tid = threadIdx.x;
    for (int i = tid; i < 3 * D; i += 256) { const int v = i / D, k = i % D; const float x = (v < 2) ? c[v * D + k] : cctx[k]; sl[v][k] = siluf_(x); }
    __syncthreads();
    const int col = cb * 64 + (tid & 63), kq = tid >> 6;
    const float* W = w_mod + (size_t)l * D * NMOD;
    float a0 = 0.f, a1 = 0.f, a2 = 0.f;
    for (int k = kq * 256; k < kq * 256 + 256; ++k) { const float w = W[(size_t)k * NMOD + col]; a0 += sl[0][k] * w; a1 += sl[1][k] * w; a2 += sl[2][k] * w; }
    red[kq][0][tid & 63] = a0; red[kq][1][tid & 63] = a1; red[kq][2][tid & 63] = a2;
    __syncthreads();
    if (tid < 192) { const int v = tid / 64, cc = tid % 64; const float s = red[0][v][cc] + red[1][v][cc] + red[2][v][cc] + red[3][v][cc];
        MOD[((size_t)l * 3 + v) * NMOD + cb * 64 + cc] = s + b_mod[(size_t)l * NMOD + cb * 64 + cc]; }
}

__global__ void __launch_bounds__(256) n_lnmod(const float* xlat, const float* xctx, const float* modl, int sh_off, int sc_off, bf16* H, int nrows) {
    const int r = (blockIdx.x * 256 + threadIdx.x) >> 6, lane = threadIdx.x & 63; if (r >= nrows) return;
    int b, t, v; bool isctx; row_info(r, b, t, v, isctx);
    const float* xr = isctx ? xctx + (size_t)(r - ML) * D : xlat + (size_t)r * D;
    f32x4 x[4]; float s = 0.f;
#pragma unroll
    for (int j = 0; j < 4; ++j) { x[j] = *(const f32x4*)(xr + 256 * j + 4 * lane); s += (x[j].x + x[j].y) + (x[j].z + x[j].w); }
    const float mean = wave_sum(s) * (1.f / D); float q = 0.f;
#pragma unroll
    for (int j = 0; j < 4; ++j) { x[j] = x[j] - mean; q += (x[j].x * x[j].x + x[j].y * x[j].y) + (x[j].z * x[j].z + x[j].w * x[j].w); }
    const float rstd = 1.f / sqrtf(wave_sum(q) * (1.f / D) + LN_EPS);
    const float* mv = modl + (size_t)v * NMOD;
#pragma unroll
    for (int j = 0; j < 4; ++j) { const int c0 = 256 * j + 4 * lane;
        const f32x4 sc = *(const f32x4*)(mv + sc_off + c0), sh = *(const f32x4*)(mv + sh_off + c0);
        const f32x4 o = x[j] * rstd * (sc + 1.0f) + sh;
        bf16* hp = H + (size_t)r * D + c0; hp[0] = f2bf(o.x); hp[1] = f2bf(o.y); hp[2] = f2bf(o.z); hp[3] = f2bf(o.w); }
}

template <class Epi> __global__ void __launch_bounds__(256) n_gemm(const bf16* A, int lda, const float* W, int ldw, int K, Epi epi) {
    __shared__ float As[16][68];
    __shared__ float Ws[16][68];
    __shared__ float T[64][65];
    const int tid = threadIdx.x, tx = tid & 15, ty = tid >> 4;
    const int row0 = blockIdx.y * 64, col0 = blockIdx.x * 64;
    float acc[4][4];
#pragma unroll
    for (int i = 0; i < 4; ++i)
#pragma unroll
        for (int j = 0; j < 4; ++j) acc[i][j] = 0.f;
    const int ar = tid >> 2, ak = (tid & 3) * 4;
    const int wr = tid >> 4, wc = (tid & 15) * 4;
    int wcols[4];
#pragma unroll
    for (int j = 0; j < 4; ++j) wcols[j] = Epi::wcol(col0 + wc + j);
    for (int k0 = 0; k0 < K; k0 += 16) {
        const bf16* ap = A + (size_t)(row0 + ar) * lda + k0 + ak;
#pragma unroll
        for (int j = 0; j < 4; ++j) As[ak + j][ar] = bf2f(ap[j]);
        const float* wp = W + (size_t)(k0 + wr) * ldw;
#pragma unroll
        for (int j = 0; j < 4; ++j) Ws[wr][wc + j] = wp[wcols[j]];
        __syncthreads();
#pragma unroll
        for (int k = 0; k < 16; ++k) {
            float a[4], w[4];
#pragma unroll
            for (int i = 0; i < 4; ++i) a[i] = As[k][4 * ty + i];
#pragma unroll
            for (int j = 0; j < 4; ++j) w[j] = Ws[k][4 * tx + j];
#pragma unroll
            for (int i = 0; i < 4; ++i)
#pragma unroll
                for (int j = 0; j < 4; ++j) acc[i][j] += a[i] * w[j];
        }
        __syncthreads();
    }
#pragma unroll
    for (int i = 0; i < 4; ++i)
#pragma unroll
        for (int j = 0; j < 4; ++j) T[4 * ty + i][4 * tx + j] = acc[i][j];
    __syncthreads();
    epi(T, row0, col0, tid);
}

struct EpiIn {
    const float* bias; bf16 *UP, *Q, *Kb, *VT, *VTC, *G;
    __device__ static __forceinline__ int wcol(int vc) { return vc < 1024 ? vc : vc + 512; }
    __device__ __forceinline__ void operator()(float (&T)[64][65], int row0, int vcol0, int tid) const {
        const int col0 = wcol(vcol0);
        if (col0 < 256) {
            for (int i = tid; i < 4096; i += 256) { const int rr = i >> 6, cc = i & 63; UP[(size_t)(row0 + rr) * PW + col0 + cc] = f2bf(T[rr][cc] + bias[col0 + cc]); }
        } else if (col0 < 896) {
            const bool isq = col0 < 768; const int head = isq ? (col0 - 256) >> 6 : (col0 - 768) >> 6;
            const int rr = tid >> 2, quarter = tid & 3, half = quarter >> 1, i0 = (quarter & 1) * 8;
            const int r = row0 + rr; int b, t, v; bool isctx; row_info(r, b, t, v, isctx);
            const float pos = (float)(half ? (t & 63) : (t >> 6));
            bf16* dst = isq ? Q + (size_t)r * AW + head * 64 : Kb + (size_t)r * KVW + head * 64;
            const float sc = isq ? C2 : 1.0f;
            for (int i = i0; i < i0 + 8; ++i) {
                const float x1 = T[rr][half * 32 + i] + bias[col0 + half * 32 + i], x2 = T[rr][half * 32 + 16 + i] + bias[col0 + half * 32 + 16 + i];
                float o1 = x1, o2 = x2;
                if (!isctx) { const float inv = exp2f(-(float)i * (13.287712379549449f / 16.0f)); const float ang = pos * inv; const float cs = cosf(ang), sn = sinf(ang); o1 = x1 * cs - x2 * sn; o2 = x1 * sn + x2 * cs; }
                dst[half * 32 + 2 * i] = f2bf(o1 * sc); dst[half * 32 + 2 * i + 1] = f2bf(o2 * sc);
            }
        } else if (col0 < 1024) {
            const int g = (col0 - 896) >> 6, d = tid & 63, rg = tid >> 6;
            for (int rr = rg * 16; rr < rg * 16 + 16; ++rr) { const int r = row0 + rr; int b, t, v; bool isctx; row_info(r, b, t, v, isctx);
                const bf16 val = f2bf(T[rr][d] + bias[col0 + d]);
                if (!isctx) VT[((size_t)(b * 2 + g) * 64 + d) * LSEQ + perm16(t)] = val; else VTC[((size_t)(b * 2 + g) * 64 + d) * CTXL + perm16(t)] = val; }
        } else {
            for (int i = tid; i < 4096; i += 256) { const int rr = i >> 6, cc = i & 63; G[(size_t)(row0 + rr) * 3072 + (col0 - 1536) + cc] = f2bf(sigmoidf_(T[rr][cc] + bias[col0 + cc])); }
        }
    }
};
struct EpiGlu {
    const float* bias; bf16 *GT, *GTCx;
    __device__ static __forceinline__ int wcol(int vc) { const int tile = vc >> 6, w = vc & 63; return 1024 + (w >> 5) * 256 + tile * 32 + (w & 31); }
    __device__ __forceinline__ void operator()(float (&T)[64][65], int row0, int vcol0, int tid) const {
        const int c0 = (vcol0 >> 6) * 32;
        for (int i = tid; i < 2048; i += 256) { const int cc = i >> 6, rr = i & 63, r = row0 + rr; int b, t, v; bool isctx; row_info(r, b, t, v, isctx);
            const float a = T[rr][cc] + bias[1024 + c0 + cc], g = T[rr][32 + cc] + bias[1280 + c0 + cc];
            const bf16 val = f2bf(a * sigmoidf_(g));
            if (!isctx) GT[((size_t)b * 256 + c0 + cc) * GTL + 16 + t] = val; else GTCx[((size_t)b * 256 + c0 + cc) * GTC + 16 + t] = val; }
    }
};
__global__ void n_gtpads(bf16* GT, bf16* GTCx) {
    const int i = blockIdx.x * 256 + threadIdx.x; if (i >= 2 * 256 * 32) return;
    const int row = i >> 5, p = i & 31;
    GT[(size_t)row * GTL + (p < 16 ? p : LSEQ + p)] = 0; GTCx[(size_t)row * GTC + (p < 16 ? p : CTXL + p)] = 0;
}
struct EpiResid {
    const float* bias; const float* modl; int g_off; const float* xin_lat; const float* xin_ctx; float* xout_lat; float* xout_ctx;
    __device__ static __forceinline__ int wcol(int vc) { return vc; }
    __device__ __forceinline__ void operator()(float (&T)[64][65], int row0, int col0, int tid) const {
        for (int i = tid; i < 4096; i += 256) { const int rr = i >> 6, cc = i & 63, r = row0 + rr, col = col0 + cc; int b, t, v; bool isctx; row_info(r, b, t, v, isctx);
            const float y = T[rr][cc] + (bias ? bias[col] : 0.f), gt = modl[(size_t)v * NMOD + g_off + col];
            if (!isctx) xout_lat[(size_t)r * D + col] = ALPHA * xin_lat[(size_t)r * D + col] + gt * y;
            else xout_ctx[(size_t)(r - ML) * D + col] = ALPHA * xin_ctx[(size_t)(r - ML) * D + col] + gt * y; }
    }
};
struct EpiMlp1 {
    const float* bias; bf16* HID;
    __device__ static __forceinline__ int wcol(int vc) { return vc; }
    __device__ __forceinline__ void operator()(float (&T)[64][65], int row0, int col0, int tid) const {
        for (int i = tid; i < 4096; i += 256) { const int rr = i >> 6, cc = i & 63; const float y = fmaxf(T[rr][cc] + bias[col0 + cc], 0.f); HID[(size_t)(row0 + rr) * FF + col0 + cc] = f2bf(y * y); }
    }
};

__global__ void __launch_bounds__(256) n_attn(const bf16* Q, const bf16* Kb, const bf16* VT, const bf16* VTC, const float* sink, bf16* P, int nrows) {
    const int wave = (blockIdx.x * 256 + threadIdx.x) >> 6, lane = threadIdx.x & 63;
    const int r = wave >> 3, hq = wave & 7; if (r >= nrows) return;
    int b, t, v; bool isctx; row_info(r, b, t, v, isctx);
    const int g = hq >> 2;
    float qf[64];
    { const u32x4* qp = (const u32x4*)(Q + (size_t)r * AW + hq * 64);
#pragma unroll
      for (int j = 0; j < 8; ++j) { const u32x4 w = qp[j];
          qf[8 * j + 0] = __uint_as_float(w.x << 16); qf[8 * j + 1] = __uint_as_float(w.x & 0xffff0000u); qf[8 * j + 2] = __uint_as_float(w.y << 16); qf[8 * j + 3] = __uint_as_float(w.y & 0xffff0000u);
          qf[8 * j + 4] = __uint_as_float(w.z << 16); qf[8 * j + 5] = __uint_as_float(w.z & 0xffff0000u); qf[8 * j + 6] = __uint_as_float(w.w << 16); qf[8 * j + 7] = __uint_as_float(w.w & 0xffff0000u); } }
    const int lo = isctx ? 0 : max(t - 128, 0), hi = isctx ? -1 : min(t + 128, LSEQ - 1);
    const int nloc = hi - lo + 1, nk = nloc + CTXL, nit = (nk + 63) >> 6;
    const int lrow0 = b * LSEQ + lo, crow0 = ML + b * CTXL;
    const float sink2 = sink[hq] * LOG2E;
    float m = sink2;
    for (int it = 0; it < nit; ++it) { const int idx = it * 64 + lane; float s = -INFINITY;
        if (idx < nk) { const int krow = idx < nloc ? lrow0 + idx : crow0 + (idx - nloc); const u32x4* kp = (const u32x4*)(Kb + (size_t)krow * KVW + g * 64); s = 0.f;
#pragma unroll
            for (int j = 0; j < 8; ++j) { const u32x4 w = kp[j];
                s += qf[8 * j + 0] * __uint_as_float(w.x << 16) + qf[8 * j + 1] * __uint_as_float(w.x & 0xffff0000u) + qf[8 * j + 2] * __uint_as_float(w.y << 16) + qf[8 * j + 3] * __uint_as_float(w.y & 0xffff0000u)
                   + qf[8 * j + 4] * __uint_as_float(w.z << 16) + qf[8 * j + 5] * __uint_as_float(w.z & 0xffff0000u) + qf[8 * j + 6] * __uint_as_float(w.w << 16) + qf[8 * j + 7] * __uint_as_float(w.w & 0xffff0000u); } }
        m = fmaxf(m, s); }
    m = wave_max(m);
    float oacc[64];
#pragma unroll
    for (int d = 0; d < 64; ++d) oacc[d] = 0.f;
    float l = 0.f;
    const bf16* vtl = VT + (size_t)(b * 2 + g) * 64 * LSEQ; const bf16* vtc = VTC + (size_t)(b * 2 + g) * 64 * CTXL;
    for (int it = 0; it < nit; ++it) { const int idx = it * 64 + lane;
        if (idx < nk) { const bool loc = idx < nloc; const int krow = loc ? lrow0 + idx : crow0 + (idx - nloc); const u32x4* kp = (const u32x4*)(Kb + (size_t)krow * KVW + g * 64); float s = 0.f;
#pragma unroll
            for (int j = 0; j < 8; ++j) { const u32x4 w = kp[j];
                s += qf[8 * j + 0] * __uint_as_float(w.x << 16) + qf[8 * j + 1] * __uint_as_float(w.x & 0xffff0000u) + qf[8 * j + 2] * __uint_as_float(w.y << 16) + qf[8 * j + 3] * __uint_as_float(w.y & 0xffff0000u)
                   + qf[8 * j + 4] * __uint_as_float(w.z << 16) + qf[8 * j + 5] * __uint_as_float(w.z & 0xffff0000u) + qf[8 * j + 6] * __uint_as_float(w.w << 16) + qf[8 * j + 7] * __uint_as_float(w.w & 0xffff0000u); }
            const float p = exp2f(s - m); l += p;
            const bf16* vp = loc ? vtl + perm16(lo + idx) : vtc + perm16(idx - nloc); const int vstride = loc ? LSEQ : CTXL;
#pragma unroll
            for (int d = 0; d < 64; ++d) oacc[d] += p * bf2f(vp[(size_t)d * vstride]); } }
    l = wave_sum(l) + exp2f(sink2 - m);
    float outv = 0.f;
#pragma unroll
    for (int d = 0; d < 64; ++d) { const float s = wave_sum(oacc[d]); if (lane == d) outv = s; }
    P[(size_t)r * D + PW + hq * 64 + lane] = f2bf(outv / l);
}

__global__ void __launch_bounds__(256) n_pool(const bf16* UP, bf16* P, int nrows) {
    const int i = blockIdx.x * 256 + threadIdx.x; const int r = i >> 5, ch = i & 31; if (r >= nrows) return;
    int b, t, v; bool isctx; row_info(r, b, t, v, isctx);
    const int g = ch >> 3, w = 2 << g, L = isctx ? CTXL : LSEQ, rbase = r - t;
    const int lo = max(t - w / 2, 0), hi = min(t + w - w / 2, L);
    float s[8];
#pragma unroll
    for (int j = 0; j < 8; ++j) s[j] = 0.f;
    for (int tt = lo; tt < hi; ++tt) { const u32x4 x = *(const u32x4*)(UP + (size_t)(rbase + tt) * PW + ch * 8);
        s[0] += __uint_as_float(x.x << 16); s[1] += __uint_as_float(x.x & 0xffff0000u); s[2] += __uint_as_float(x.y << 16); s[3] += __uint_as_float(x.y & 0xffff0000u);
        s[4] += __uint_as_float(x.z << 16); s[5] += __uint_as_float(x.z & 0xffff0000u); s[6] += __uint_as_float(x.w << 16); s[7] += __uint_as_float(x.w & 0xffff0000u); }
    const float inv = 1.0f / (float)(hi - lo);
    const bf16* up = UP + (size_t)r * PW + ch * 8; bf16* pp = P + (size_t)r * D + ch * 8;
#pragma unroll
    for (int j = 0; j < 8; ++j) pp[j] = f2bf(s[j] * inv - bf2f(up[j]));
}
__global__ void __launch_bounds__(256) n_poolproj(const bf16* P, const float* pool_w, const float* pool_scale, bf16* E) {
    __shared__ float dl[256];
    const int r = blockIdx.x, c = threadIdx.x; dl[c] = bf2f(P[(size_t)r * D + c]); __syncthreads();
    const int g = c >> 6, dd = c & 63; float s = 0.f;
    for (int k = 0; k < 64; ++k) s += dl[g * 64 + k] * pool_w[((size_t)g * 64 + k) * 64 + dd];
    E[(size_t)r * PW + c] = f2bf(s * pool_scale[c]);
}
__global__ void __launch_bounds__(256) n_conv(const bf16* GT, const bf16* GTCx, const float* conv_w, const float* conv_b, const float* ln_g, const float* ln_b, bf16* P) {
    __shared__ float red[8];
    const int r = blockIdx.x, c = threadIdx.x; int b, t, v; bool isctx; row_info(r, b, t, v, isctx);
    const bf16* gp = isctx ? GTCx + ((size_t)b * 256 + c) * GTC + 16 + t - 15 : GT + ((size_t)b * 256 + c) * GTL + 16 + t - 15;
    float y = conv_b[c];
    for (int k = 0; k < 31; ++k) y += conv_w[k * CW + c] * bf2f(gp[k]);
    float s = wave_sum(y); if ((c & 63) == 0) red[c >> 6] = s; __syncthreads();
    const float mean = (red[0] + red[1] + red[2] + red[3]) * (1.f / CW); const float dv = y - mean;
    float q = wave_sum(dv * dv); if ((c & 63) == 0) red[4 + (c >> 6)] = q; __syncthreads();
    const float rstd = 1.f / sqrtf((red[4] + red[5] + red[6] + red[7]) * (1.f / CW) + LN_EPS);
    const float z = dv * rstd * ln_g[c] + ln_b[c];
    P[(size_t)r * D + 768 + c] = f2bf(siluf_(z));
}
__global__ void __launch_bounds__(256) n_merge(const bf16* E, const bf16* P, const float* Wp, const float* Wa, const float* Wc, const bf16* G, bf16* MG) {
    __shared__ float As[16][68];
    __shared__ float Ws[16][68];
    const int tid = threadIdx.x, tx = tid & 15, ty = tid >> 4; const int row0 = blockIdx.y * 64, col0 = blockIdx.x * 64;
    const int ar = tid >> 2, ak = (tid & 3) * 4, wr = tid >> 4, wc = (tid & 15) * 4;
    float tot[4][4];
#pragma unroll
    for (int i = 0; i < 4; ++i)
#pragma unroll
        for (int j = 0; j < 4; ++j) tot[i][j] = 0.f;
    for (int seg = 0; seg < 3; ++seg) {
        const bf16* A = seg == 0 ? E : (seg == 1 ? P + PW : P + 768); const int lda = seg == 0 ? PW : D; const int K = seg == 1 ? AW : 256; const float* W = seg == 0 ? Wp : (seg == 1 ? Wa : Wc);
        float acc[4][4];
#pragma unroll
        for (int i = 0; i < 4; ++i)
#pragma unroll
            for (int j = 0; j < 4; ++j) acc[i][j] = 0.f;
        for (int k0 = 0; k0 < K; k0 += 16) {
            const bf16* ap = A + (size_t)(row0 + ar) * lda + k0 + ak;
#pragma unroll
            for (int j = 0; j < 4; ++j) As[ak + j][ar] = bf2f(ap[j]);
            const float* wp = W + (size_t)(k0 + wr) * D + col0 + wc;
#pragma unroll
            for (int j = 0; j < 4; ++j) Ws[wr][wc + j] = wp[j];
            __syncthreads();
#pragma unroll
            for (int k = 0; k < 16; ++k) {
#pragma unroll
                for (int i = 0; i < 4; ++i)
#pragma unroll
                    for (int j = 0; j < 4; ++j) acc[i][j] += As[k][4 * ty + i] * Ws[k][4 * tx + j];
            }
            __syncthreads();
        }
#pragma unroll
        for (int i = 0; i < 4; ++i)
#pragma unroll
            for (int j = 0; j < 4; ++j) tot[i][j] += bf2f(G[(size_t)(row0 + 4 * ty + i) * 3072 + seg * D + col0 + 4 * tx + j]) * acc[i][j];
    }
#pragma unroll
    for (int i = 0; i < 4; ++i)
#pragma unroll
        for (int j = 0; j < 4; ++j) MG[(size_t)(row0 + 4 * ty + i) * D + col0 + 4 * tx + j] = f2bf(tot[i][j]);
}
__global__ void __launch_bounds__(256) n_postnorm(float* xlat, float* xctx, const float* lg, const float* lb, int nrows) {
    const int r = (blockIdx.x * 256 + threadIdx.x) >> 6, lane = threadIdx.x & 63; if (r >= nrows) return;
    float* xr = r < ML ? xlat + (size_t)r * D : xctx + (size_t)(r - ML) * D;
    f32x4 x[4]; float s = 0.f;
#pragma unroll
    for (int j = 0; j < 4; ++j) { x[j] = *(const f32x4*)(xr + 256 * j + 4 * lane); s += (x[j].x + x[j].y) + (x[j].z + x[j].w); }
    const float mean = wave_sum(s) * (1.f / D); float q = 0.f;
#pragma unroll
    for (int j = 0; j < 4; ++j) { x[j] = x[j] - mean; q += (x[j].x * x[j].x + x[j].y * x[j].y) + (x[j].z * x[j].z + x[j].w * x[j].w); }
    const float rstd = 1.f / sqrtf(wave_sum(q) * (1.f / D) + LN_EPS);
#pragma unroll
    for (int j = 0; j < 4; ++j) { const int c0 = 256 * j + 4 * lane; const f32x4 gg = *(const f32x4*)(lg + c0), bb = *(const f32x4*)(lb + c0);
        *(f32x4*)(xr + c0) = x[j] * rstd * gg + bb; }
}

extern "C" void kernel_launch(void* const* d_in, const int* in_sizes, int n_in, void* d_out, int out_size, void* d_ws, size_t ws_size, hipStream_t stream) {
    if (n_in != 27 || ws_size < WS_END || out_size != ML * D) { fprintf(stderr, "kernel_launch: unexpected arguments (n_in %d, ws %zu, out %d)\n", n_in, ws_size, out_size); return; }
    const float* x = (const float*)d_in[0]; const float* c = (const float*)d_in[1]; const float* ctx = (const float*)d_in[2]; const float* cctx = (const float*)d_in[3];
    const float* w_mod = (const float*)d_in[4]; const float* b_mod = (const float*)d_in[5]; const float* w_in = (const float*)d_in[6]; const float* b_in = (const float*)d_in[7];
    const float* pool_w = (const float*)d_in[8]; const float* pool_scale = (const float*)d_in[9]; const float* w_pool_out = (const float*)d_in[10]; const float* attn_sink = (const float*)d_in[11];
    const float* w_attn_out = (const float*)d_in[12]; const float* conv_w = (const float*)d_in[13]; const float* conv_b = (const float*)d_in[14]; const float* conv_ln_g = (const float*)d_in[15];
    const float* conv_ln_b = (const float*)d_in[16]; const float* w_conv_out = (const float*)d_in[17]; const float* w_out = (const float*)d_in[18]; const float* ln1_g = (const float*)d_in[19];
    const float* ln1_b = (const float*)d_in[20]; const float* w_mlp1 = (const float*)d_in[21]; const float* b_mlp1 = (const float*)d_in[22]; const float* w_mlp2 = (const float*)d_in[23];
    const float* b_mlp2 = (const float*)d_in[24]; const float* ln2_g = (const float*)d_in[25]; const float* ln2_b = (const float*)d_in[26];
    float* out = (float*)d_out; unsigned char* ws = (unsigned char*)d_ws;
    float* MOD = (float*)(ws + WS_MOD); float* XC = (float*)(ws + WS_XC);
    bf16* H = (bf16*)(ws + WS_H); bf16* G = (bf16*)(ws + WS_G); bf16* Qb = (bf16*)(ws + WS_Q); bf16* UP = (bf16*)(ws + WS_UP); bf16* Kb = (bf16*)(ws + WS_K);
    bf16* VT = (bf16*)(ws + WS_VT); bf16* VTC = (bf16*)(ws + WS_VTC); bf16* GT = (bf16*)(ws + WS_GT); bf16* GTCx = (bf16*)(ws + WS_GTC); bf16* E = (bf16*)(ws + WS_E);
    bf16* MG = (bf16*)(ws + WS_MG); bf16* HID = (bf16*)(ws + WS_HID); bf16* P = H;

    n_mod<<<192, 256, 0, stream>>>(c, cctx, w_mod, b_mod, MOD);
    for (int l = 0; l < DEPTH; ++l) {
        const bool last = (l == DEPTH - 1);
        const float* modl = MOD + (size_t)l * 3 * NMOD;
        const float* xin_lat = (l == 0) ? x : out; const float* xin_ctx = (l == 0) ? ctx : XC;
        const int Mr = last ? ML : MT;
        n_lnmod<<<MT / 4, 256, 0, stream>>>(xin_lat, xin_ctx, modl, 0, D, H, MT);
        { EpiIn e{b_in + (size_t)l * INW, UP, Qb, Kb, VT, VTC, G};
          n_gemm<EpiIn><<<dim3(4096 / 64, MT / 64), 256, 0, stream>>>(H, D, w_in + (size_t)l * D * INW, INW, D, e); }
        { EpiGlu e{b_in + (size_t)l * INW, GT, GTCx};
          n_gemm<EpiGlu><<<dim3(512 / 64, MT / 64), 256, 0, stream>>>(H, D, w_in + (size_t)l * D * INW, INW, D, e); }
        n_gtpads<<<(2 * 256 * 32 + 255) / 256, 256, 0, stream>>>(GT, GTCx);
        n_attn<<<Mr * 8 / 4, 256, 0, stream>>>(Qb, Kb, VT, VTC, attn_sink + l * 8, P, Mr);
        n_pool<<<Mr * 32 / 256, 256, 0, stream>>>(UP, P, Mr);
        n_conv<<<Mr, 256, 0, stream>>>(GT, GTCx, conv_w + (size_t)l * 31 * CW, conv_b + l * CW, conv_ln_g + l * CW, conv_ln_b + l * CW, P);
        n_poolproj<<<Mr, 256, 0, stream>>>(P, pool_w + (size_t)l * 4 * 64 * 64, pool_scale + l * PW, E);
        n_merge<<<dim3(D / 64, Mr / 64), 256, 0, stream>>>(E, P, w_pool_out + (size_t)l * PW * D, w_attn_out + (size_t)l * AW * D, w_conv_out + (size_t)l * CW * D, G, MG);
        { EpiResid e{nullptr, modl, 2 * D, xin_lat, xin_ctx, out, XC};
          n_gemm<EpiResid><<<dim3(D / 64, Mr / 64), 256, 0, stream>>>(MG, D, w_out + (size_t)l * D * D, D, D, e); }
        n_postnorm<<<Mr / 4, 256, 0, stream>>>(out, XC, ln1_g + l * D, ln1_b + l * D, Mr);
        n_lnmod<<<Mr / 4, 256, 0, stream>>>(out, XC, modl, 3 * D, 4 * D, H, Mr);
        { EpiMlp1 e{b_mlp1 + (size_t)l * FF, HID};
          n_gemm<EpiMlp1><<<dim3(FF / 64, Mr / 64), 256, 0, stream>>>(H, D, w_mlp1 + (size_t)l * D * FF, FF, D, e); }
        { EpiResid e{b_mlp2 + (size_t)l * D, modl, 5 * D, out, XC, out, XC};
          n_gemm<EpiResid><<<dim3(D / 64, Mr / 64), 256, 0, stream>>>(HID, FF, w_mlp2 + (size_t)l * FF * D, D, FF, e); }
        n_postnorm<<<Mr / 4, 256, 0, stream>>>(out, XC, ln2_g + l * D, ln2_b + l * D, Mr);
    }
}
```
